# Optimizing an MI355X kernel written in HIP

```python
import jax, jax.numpy as jnp
from jax import lax
import numpy as np

D_MODEL = 2048
BATCH = 4
SEQ = 2048
DEPTH = 1
DEC_BATCH = 32
DEC_SEQ = 8
PAST_LEN = 16384
PAGE_SIZE = 128

HEAD_DIM = 64
ATTN_WIDTH = D_MODEL // 2
N_HEADS = ATTN_WIDTH // HEAD_DIM
CONV_CH = D_MODEL - ATTN_WIDTH
MIX_WIDTH = ATTN_WIDTH + CONV_CH
IN_WIDTH = 3 * ATTN_WIDTH + 2 * CONV_CH
CONV_WIDTH = 31
CONV_STATE = CONV_WIDTH - 1
DILATED = ((128, 1), (512, 4), (2048, 16))
MAX_WINDOW = 2048
Q_BLOCK = 128
D_FF = 5632
ROPE_THETA = 10000.0
EPS = 1e-6
FFN_RES = 0.5

kernel_name = "hymba_dilated_attn_conformer_conv_macaron"


def rmsnorm(x, g):
    xf = x.astype(jnp.float32)
    y = xf * lax.rsqrt(jnp.mean(xf * xf, axis=-1, keepdims=True) + EPS)
    return (y * g.astype(jnp.float32)).astype(x.dtype)


def layernorm(x, g, b):
    xf = x.astype(jnp.float32)
    mu = jnp.mean(xf, axis=-1, keepdims=True)
    xc = xf - mu
    y = xc * lax.rsqrt(jnp.mean(xc * xc, axis=-1, keepdims=True) + EPS)
    return (y * g.astype(jnp.float32) + b.astype(jnp.float32)).astype(x.dtype)


def rope(x, pos):
    half = HEAD_DIM // 2
    inv = ROPE_THETA ** (-jnp.arange(half, dtype=jnp.float32) / half)
    ang = pos.astype(jnp.float32)[:, None] * inv[None, :]
    cos = jnp.cos(ang)[:, None, :]
    sin = jnp.sin(ang)[:, None, :]
    x1 = x[..., :half].astype(jnp.float32)
    x2 = x[..., half:].astype(jnp.float32)
    out = jnp.concatenate([x1 * cos - x2 * sin, x2 * cos + x1 * sin], axis=-1)
    return out.astype(x.dtype)


def ffn_half(x, g, wg, wu, wd):
    h = rmsnorm(x, g)
    return x + FFN_RES * ((jax.nn.silu(h @ wg) * (h @ wu)) @ wd)


def mixer_inputs(h, w_in, g_q, g_k, pos):
    z = h @ w_in
    q, k, v, c = jnp.split(z, [ATTN_WIDTH, 2 * ATTN_WIDTH, 3 * ATTN_WIDTH], axis=-1)
    shp = h.shape[:-1] + (N_HEADS, HEAD_DIM)
    q = rope(rmsnorm(q.reshape(shp), g_q), pos)
    k = rope(rmsnorm(k.reshape(shp), g_k), pos)
    v = v.reshape(shp)
    a, b = jnp.split(c, 2, axis=-1)
    u = a * jax.nn.sigmoid(b)
    return q, k, v, u


def dilated_prompt(q, k, v, d, span):
    B, S, H, Dh = q.shape
    L = S // d
    nb = -(-L // Q_BLOCK)
    Lp = nb * Q_BLOCK

    def by_residue(x):
        return x.reshape(B, L, d, H, Dh).transpose(0, 2, 1, 3, 4)

    qr, kr, vr = by_residue(q), by_residue(k), by_residue(v)
    kpad = ((0, 0), (0, 0), (Q_BLOCK, Lp - L), (0, 0), (0, 0))
    kb = jnp.pad(kr, kpad).reshape(B, d, nb + 1, Q_BLOCK, H, Dh)
    vb = jnp.pad(vr, kpad).reshape(B, d, nb + 1, Q_BLOCK, H, Dh)
    qb = jnp.pad(qr, ((0, 0), (0, 0), (0, Lp - L), (0, 0), (0, 0))).reshape(B, d, nb, Q_BLOCK, H, Dh)
    kband = jnp.concatenate([kb[:, :, :-1], kb[:, :, 1:]], axis=3)
    vband = jnp.concatenate([vb[:, :, :-1], vb[:, :, 1:]], axis=3)
    s = jnp.einsum('brnqhd,brnkhd->brnhqk', qb, kband,
                   preferred_element_type=jnp.float32) * (HEAD_DIM ** -0.5)
    qi = jnp.arange(Q_BLOCK)[:, None]
    ki = jnp.arange(2 * Q_BLOCK)[None, :]
    rel = qi + Q_BLOCK - ki
    key_m = jnp.arange(nb)[:, None, None] * Q_BLOCK - Q_BLOCK + ki
    mask = (rel >= 0) & (rel <= span) & (key_m >= 0)
    s = jnp.where(mask[:, None], s, -jnp.inf)
    lse = jax.nn.logsumexp(s, axis=-1)
    p = jnp.exp(s - lse[..., None])
    o = jnp.einsum('brnhqk,brnkhd->brnqhd', p, vband.astype(jnp.float32))
    o = o.reshape(B, d, Lp, H, Dh)[:, :, :L].transpose(0, 2, 1, 3, 4).reshape(B, S, H, Dh)
    lse = lse.transpose(0, 1, 2, 4, 3).reshape(B, d, Lp, H)[:, :, :L]
    lse = lse.transpose(0, 2, 1, 3).reshape(B, S, H)
    return o, lse


def dilated_sample(q, k_all, v_all, buf_len, d, span):
    T = q.shape[1]
    j = jnp.arange(span + 1)
    idx = buf_len + jnp.arange(T)[:, None] - d * j[None, :]
    valid = idx >= 0
    idxc = jnp.maximum(idx, 0)
    kg = k_all[:, idxc]
    vg = v_all[:, idxc]
    s = jnp.einsum('bthd,btjhd->bthj', q, kg,
                   preferred_element_type=jnp.float32) * (HEAD_DIM ** -0.5)
    s = jnp.where(valid[:, None, :], s, -jnp.inf)
    lse = jax.nn.logsumexp(s, axis=-1)
    p = jnp.exp(s - lse[..., None])
    o = jnp.einsum('bthj,btjhd->bthd', p, vg.astype(jnp.float32))
    return o, lse


def dilated_mixture(parts):
    o = jnp.stack([p[0] for p in parts])
    lse = jnp.stack([p[1] for p in parts])
    w = jax.nn.softmax(lse, axis=0)
    return jnp.einsum('pbsh,pbshd->bshd', w, o)


def conv_branch(u_ext, dw_w, dw_b, ln_g, ln_b):
    y = lax.conv_general_dilated(u_ext, dw_w.astype(u_ext.dtype)[:, None, :],
                                 window_strides=(1,), padding='VALID',
                                 dimension_numbers=('NWC', 'WIO', 'NWC'),
                                 feature_group_count=CONV_CH)
    return jax.nn.silu(layernorm(y + dw_b, ln_g, ln_b))


def mix_out(attn, conv, w_out):
    B, S = conv.shape[:2]
    cat = jnp.concatenate([attn.astype(conv.dtype).reshape(B, S, ATTN_WIDTH), conv], axis=-1)
    return cat @ w_out


def setup_inputs(seed: int = 0) -> dict:
    key = jax.random.key(seed)
    ks = jax.random.split(key, 24)
    f32 = jnp.float32
    kv_buf = min(MAX_WINDOW, PAST_LEN)
    nrm = lambda k, shp, sc: jax.random.normal(k, shp, f32) * sc
    gain = lambda k, shp: 1.0 + 0.02 * jax.random.normal(k, shp, f32)
    return {
        "x_prompt": nrm(ks[0], (BATCH, SEQ, D_MODEL), 1.0),
        "x_sample": nrm(ks[1], (DEC_BATCH, DEC_SEQ, D_MODEL), 1.0),
        "cache_k": nrm(ks[2], (DEPTH, DEC_BATCH, kv_buf, N_HEADS, HEAD_DIM), 1.0),
        "cache_v": nrm(ks[3], (DEPTH, DEC_BATCH, kv_buf, N_HEADS, HEAD_DIM), 1.0),
        "state_conv": nrm(ks[4], (DEPTH, DEC_BATCH, CONV_STATE, CONV_CH), 0.5),
        "ln_ffn1": gain(ks[5], (DEPTH, D_MODEL)),
        "ffn1_w_gate": nrm(ks[6], (DEPTH, D_MODEL, D_FF), D_MODEL ** -0.5),
        "ffn1_w_up": nrm(ks[7], (DEPTH, D_MODEL, D_FF), D_MODEL ** -0.5),
        "ffn1_w_down": nrm(ks[8], (DEPTH, D_FF, D_MODEL), D_FF ** -0.5),
        "ln_mix": gain(ks[9], (DEPTH, D_MODEL)),
        "w_in": nrm(ks[10], (DEPTH, D_MODEL, IN_WIDTH), D_MODEL ** -0.5),
        "q_norm": gain(ks[11], (DEPTH, HEAD_DIM)),
        "k_norm": gain(ks[12], (DEPTH, HEAD_DIM)),
        "conv_dw_w": nrm(ks[13], (DEPTH, CONV_WIDTH, CONV_CH), CONV_WIDTH ** -0.5),
        "conv_dw_b": nrm(ks[14], (DEPTH, CONV_CH), 0.02),
        "conv_ln_g": gain(ks[15], (DEPTH, CONV_CH)),
        "conv_ln_b": nrm(ks[16], (DEPTH, CONV_CH), 0.02),
        "w_out": nrm(ks[17], (DEPTH, MIX_WIDTH, D_MODEL), MIX_WIDTH ** -0.5),
        "ln_ffn2": gain(ks[18], (DEPTH, D_MODEL)),
        "ffn2_w_gate": nrm(ks[19], (DEPTH, D_MODEL, D_FF), D_MODEL ** -0.5),
        "ffn2_w_up": nrm(ks[20], (DEPTH, D_MODEL, D_FF), D_MODEL ** -0.5),
        "ffn2_w_down": nrm(ks[21], (DEPTH, D_FF, D_MODEL), D_FF ** -0.5),
    }


def reference(x_prompt, x_sample, cache_k, cache_v, state_conv, ln_ffn1, ffn1_w_gate,
              ffn1_w_up, ffn1_w_down, ln_mix, w_in, q_norm, k_norm, conv_dw_w, conv_dw_b,
              conv_ln_g, conv_ln_b, w_out, ln_ffn2, ffn2_w_gate, ffn2_w_up, ffn2_w_down):
    S = x_prompt.shape[1]
    T = x_sample.shape[1]
    buf_len = cache_k.shape[2]
    pos_p = jnp.arange(S)
    pos_s = PAST_LEN + jnp.arange(T)
    hp, hs = x_prompt, x_sample
    kp_l, vp_l, cp_l, ks_l, vs_l, cs_l = [], [], [], [], [], []
    for l in range(DEPTH):
        hp = ffn_half(hp, ln_ffn1[l], ffn1_w_gate[l], ffn1_w_up[l], ffn1_w_down[l])
        hs = ffn_half(hs, ln_ffn1[l], ffn1_w_gate[l], ffn1_w_up[l], ffn1_w_down[l])

        q, k, v, u = mixer_inputs(rmsnorm(hp, ln_mix[l]), w_in[l], q_norm[l], k_norm[l], pos_p)
        attn = dilated_mixture([dilated_prompt(q, k, v, d, w // d) for (w, d) in DILATED])
        u_ext = jnp.pad(u, ((0, 0), (CONV_STATE, 0), (0, 0)))
        conv = conv_branch(u_ext, conv_dw_w[l], conv_dw_b[l], conv_ln_g[l], conv_ln_b[l])
        hp = hp + mix_out(attn, conv, w_out[l])
        kp_l.append(k[:, -min(MAX_WINDOW, S):])
        vp_l.append(v[:, -min(MAX_WINDOW, S):])
        cp_l.append(u_ext[:, -CONV_STATE:])

        q, k, v, u = mixer_inputs(rmsnorm(hs, ln_mix[l]), w_in[l], q_norm[l], k_norm[l], pos_s)
        k_all = jnp.concatenate([cache_k[l].astype(k.dtype), k], axis=1)
        v_all = jnp.concatenate([cache_v[l].astype(v.dtype), v], axis=1)
        attn = dilated_mixture([dilated_sample(q, k_all, v_all, buf_len, d, w // d)
                                for (w, d) in DILATED])
        u_ext = jnp.concatenate([state_conv[l].astype(u.dtype), u], axis=1)
        conv = conv_branch(u_ext, conv_dw_w[l], conv_dw_b[l], conv_ln_g[l], conv_ln_b[l])
        hs = hs + mix_out(attn, conv, w_out[l])
        ks_l.append(k)
        vs_l.append(v)
        cs_l.append(u_ext[:, -CONV_STATE:])

        hp = ffn_half(hp, ln_ffn2[l], ffn2_w_gate[l], ffn2_w_up[l], ffn2_w_down[l])
        hs = ffn_half(hs, ln_ffn2[l], ffn2_w_gate[l], ffn2_w_up[l], ffn2_w_down[l])
    return (hp, hs, jnp.stack(kp_l), jnp.stack(vp_l), jnp.stack(cp_l),
            jnp.stack(ks_l), jnp.stack(vs_l), jnp.stack(cs_l))
```

```cpp
#include <hip/hip_runtime.h>
#include <cstdio>
#include <cstdint>

#ifndef MK_N_LAUNCHES
#define MK_N_LAUNCHES 1
#endif

#define LAS __attribute__((address_space(3)))
typedef unsigned short bf16_t;
typedef short bf16x8 __attribute__((ext_vector_type(8)));
typedef float f32x4 __attribute__((ext_vector_type(4)));
typedef float f32x2 __attribute__((ext_vector_type(2)));
typedef float f32x16 __attribute__((ext_vector_type(16)));
typedef unsigned u32x4 __attribute__((ext_vector_type(4)));
typedef unsigned u32x2 __attribute__((ext_vector_type(2)));
typedef short s16x4 __attribute__((ext_vector_type(4)));

constexpr int D = 2048, FF = 5632, NIN = 5120, AW = 1024, CC = 1024, NH = 16, HD = 64;
constexpr int MP = 8192, MS = 256, M = MP + MS, SEQ = 2048, NB = 4, SB = 32, ST = 8, KVBUF = 2048;
constexpr int CW = 31, CST = 30;
constexpr float EPS = 1e-6f;
constexpr float LOG2E = 1.4426950408889634f;
constexpr float QSCALE = 0.125f * LOG2E;

constexpr size_t O_Y = 0, O_KP = (size_t)M * D, O_VP = O_KP + (size_t)MP * AW, O_CP = O_VP + (size_t)MP * AW, O_KS = O_CP + (size_t)NB * CST * CC,
                 O_VS = O_KS + (size_t)MS * AW, O_CS = O_VS + (size_t)MS * AW, O_END = O_CS + (size_t)SB * CST * CC;

constexpr size_t MiB = 1u << 20;
constexpr size_t WS_CTL = 0, CTL_BYTES = 64 * 1024;
constexpr size_t WS_BT1 = 1 * MiB;
constexpr size_t WS_BTD1 = WS_BT1 + (size_t)2 * FF * D * 2;
constexpr size_t WS_BTI = WS_BTD1 + (size_t)D * FF * 2;
constexpr size_t WS_BTO = WS_BTI + (size_t)NIN * D * 2;
constexpr size_t WS_BT2 = WS_BTO + (size_t)D * D * 2;
constexpr size_t WS_BTD2 = WS_BT2 + (size_t)2 * FF * D * 2;
constexpr size_t WS_HB = WS_BTD2 + (size_t)D * FF * 2;
constexpr size_t WS_ACT = WS_HB + (size_t)M * D * 2;
constexpr size_t WS_QB = WS_ACT + (size_t)M * FF * 2;
constexpr size_t WS_KB = WS_QB + (size_t)M * AW * 2;
constexpr size_t WS_VB = WS_KB + (size_t)M * AW * 2;
constexpr size_t WS_U = WS_VB + (size_t)M * AW * 2;
constexpr size_t WS_CAT = WS_U + (size_t)M * CC * 4;
constexpr size_t WS_OP = WS_CAT + (size_t)M * D * 2;
constexpr size_t WS_ML = WS_OP + (size_t)3 * M * AW * 4;
constexpr size_t WS_SSQ = WS_ML + (size_t)3 * M * NH * 2 * 4;
constexpr size_t WS_ROPE = WS_SSQ + (size_t)3 * M * 32 * 4;
constexpr size_t WS_END = WS_ROPE + (size_t)2 * 2056 * 32 * 4;
constexpr int CW_BAR = 1024;

constexpr int RING_BYTES = 131072, RS_OFF = RING_BYTES  , MISC_OFF = 147456 - 512, PTAB_OFF = 147456 - 256  , LDS_BYTES = 147456;

namespace pg8 {
constexpr int BM = 256, BK = 64, HALF = 128, HTB = HALF * BK * 2, STAGE_BYTES = 8 * HTB, NXCD = 8, WGM = 8;
__host__ __device__ __forceinline__ int lds_byte(int r, int c) { const int st = (r >> 4) * 2 + (c >> 5), rr = r & 15, cc = c & 31, ob = rr * 64 + cc * 2; return st * 1024 + (ob ^ (((ob >> 9) & 1) << 5)); }
__host__ __device__ __forceinline__ void stage_rc(int b, int& R, int& C) { const int st = b / 1024, sb = b % 1024, swz = sb ^ (((sb >> 9) & 1) << 5); R = (st >> 1) * 16 + swz / 64; C = (st & 1) * 32 + (swz % 64) / 2; }
__host__ __device__ __forceinline__ int perm32(int rho) { const int n = rho >> 4, i = rho & 15; return 8 * (i >> 2) + 4 * n + (i & 3); }

struct Unit { int pm, pn; };
struct Gemm { const bf16_t* A; const bf16_t* Bt; int M, N, K; };

struct StaticOrder {
    int nM, nN, nwg, G, c;
    __host__ __device__ __forceinline__ void init(int M_, int N_, int G_, int c_) { nM = M_ / BM; nN = N_ / BM; nwg = nM * nN; G = G_; c = c_; }
    __host__ __device__ __forceinline__ bool next(int i, Unit& u) const {
        const long L = (long)i * G + c; if (L >= nwg) return false;
        int wgid = (int)L; { const int q = nwg / NXCD, r = nwg % NXCD, xcd = wgid % NXCD, off = wgid / NXCD; wgid = (xcd < r ? xcd * (q + 1) : r * (q + 1) + (xcd - r) * q) + off; }
        const int nig = WGM * nN, gid = wgid / nig, fm = gid * WGM, gsz = (nM - fm) < WGM ? (nM - fm) : WGM;
        u.pm = fm + ((wgid % nig) % gsz); u.pn = (wgid % nig) / gsz; return true;
    }
};

__device__ __forceinline__ unsigned cvt_pk_bf16(float lo, float hi) { unsigned r; asm volatile("v_cvt_pk_bf16_f32 %0, %1, %2" : "=v"(r) : "v"(lo), "v"(hi)); return r; }

template <class Epi, class Sched, bool ALIGN_EPI = false, bool SP2 = false>
__device__ __forceinline__ void gemm_phase(LAS unsigned char* lds, const Gemm g, const Sched& S, const Epi& E, const int tid) {
    const int wid = __builtin_amdgcn_readfirstlane(tid >> 6), lane = tid & 63, wr = wid >> 2, wc = wid & 3, fr = lane & 15, fq = lane >> 4;
    const int K = g.K, nt = K / BK;
    unsigned voffA[2], voffB[2];
#pragma unroll
    for (int i = 0; i < 2; ++i) { int R, C; stage_rc(tid * 16 + i * 8192, R, C); const int Rb = Epi::PERM ? ((R & ~31) + perm32(R & 31)) : R;
        voffA[i] = (unsigned)(R * K + C) * 2u; voffB[i] = (unsigned)(Rb * K + C) * 2u; }
    const size_t kstep = (size_t)(BK * 2);
    const size_t hstep = (size_t)HALF * K * 2;
    const size_t tstep = 2 * hstep;
    const unsigned ldsw = (unsigned)wid * 1024u;
    const int aoff = lds_byte(wr * 64 + fr, fq * 8), boff = lds_byte(wc * 32 + fr, fq * 8);
#define PG8_SA(b, h) (((b) * 2 + (h)) * HTB)
#define PG8_SB(b, h) ((4 + (b) * 2 + (h)) * HTB)
#define PG8_STAGE(bufoff, gbase, voff) do { _Pragma("unroll") for (int _i = 0; _i < 2; ++_i) \
        __builtin_amdgcn_global_load_lds((const unsigned*)((const char*)(gbase) + (voff)[_i]), (LAS unsigned*)(lds + (bufoff) + ldsw + _i * 8192), 16, 0, 0); } while (0)
#define PG8_LDA(dst, b, h) do { _Pragma("unroll") for (int m = 0; m < 4; ++m) _Pragma("unroll") for (int k = 0; k < 2; ++k) dst[m][k] = *(const LAS bf16x8*)(lds + PG8_SA(b, h) + aoff + m * 2048 + k * 1024); } while (0)
#define PG8_LDB(dst, b, h) do { _Pragma("unroll") for (int n = 0; n < 2; ++n) _Pragma("unroll") for (int k = 0; k < 2; ++k) dst[n][k] = *(const LAS bf16x8*)(lds + PG8_SB(b, h) + boff + n * 2048 + k * 1024); } while (0)
#define PG8_MMA(ai, bj, At, Bt) do { __builtin_amdgcn_s_setprio(1); _Pragma("unroll") for (int m = 0; m < 4; ++m) _Pragma("unroll") for (int n = 0; n < 2; ++n) _Pragma("unroll") for (int k = 0; k < 2; ++k) \
        acc[ai][bj][m][n] = __builtin_amdgcn_mfma_f32_16x16x32_bf16(Bt[n][k], At[m][k], acc[ai][bj][m][n], 0, 0, 0); __builtin_amdgcn_s_setprio(0); } while (0)
#define PG8_WAIT_V(n) asm volatile("s_waitcnt vmcnt(" #n ")" ::: "memory")
#define PG8_WAIT_L(n) asm volatile("s_waitcnt lgkmcnt(" #n ")" ::: "memory")
#define PG8_BAR __builtin_amdgcn_s_barrier()
#define PG8_SCHED __builtin_amdgcn_sched_barrier(0)
    Unit cur, nxt; int ui = 0;
    if (!S.next(0, cur)) return;
    f32x4 acc[2][2][4][2];
#pragma unroll
    for (int a = 0; a < 2; ++a)
#pragma unroll
        for (int b = 0; b < 2; ++b)
#pragma unroll
            for (int m = 0; m < 4; ++m)
#pragma unroll
                for (int n = 0; n < 2; ++n) acc[a][b][m][n] = (f32x4){0.f, 0.f, 0.f, 0.f};
    bf16x8 At[4][2], B0[2][2], B1[2][2];
    const char* cA = (const char*)g.A + (size_t)cur.pm * tstep; const char* cB = (const char*)g.Bt + (size_t)cur.pn * tstep;
    if constexpr (SP2) {
        PG8_STAGE(PG8_SB(0, 0), cB, voffB); PG8_STAGE(PG8_SB(0, 1), cB + hstep, voffB); PG8_STAGE(PG8_SA(0, 0), cA, voffA); PG8_STAGE(PG8_SA(0, 1), cA + hstep, voffA);
        if (wr == 1) PG8_BAR;
        PG8_WAIT_V(2); PG8_BAR;
        PG8_STAGE(PG8_SB(1, 0), cB + kstep, voffB); PG8_STAGE(PG8_SA(1, 0), cA + kstep, voffA); PG8_STAGE(PG8_SB(1, 1), cB + hstep + kstep, voffB);
        PG8_WAIT_V(6); PG8_BAR;
    } else {
        PG8_STAGE(PG8_SB(0, 0), cB, voffB); PG8_STAGE(PG8_SA(0, 0), cA, voffA); PG8_STAGE(PG8_SB(0, 1), cB + hstep, voffB); PG8_STAGE(PG8_SA(0, 1), cA + hstep, voffA);
        if (wr == 1) PG8_BAR;
        PG8_WAIT_V(4); PG8_BAR;
        PG8_STAGE(PG8_SB(1, 0), cB + kstep, voffB); PG8_STAGE(PG8_SA(1, 0), cA + kstep, voffA); PG8_STAGE(PG8_SB(1, 1), cB + hstep + kstep, voffB);
        PG8_WAIT_V(6); PG8_BAR;
    }
    for (;;) {
        const bool has_next = S.next(ui + 1, nxt);
        const char* nA = has_next ? (const char*)g.A + (size_t)nxt.pm * tstep : cA; const char* nB = has_next ? (const char*)g.Bt + (size_t)nxt.pn * tstep : cB;
        for (int t = 0; t < nt; t += 2) {
            const bool last = (t == nt - 2);
            const char* a1 = cA + (size_t)(t + 1) * kstep;
            const char* a2 = last ? nA : cA + (size_t)(t + 2) * kstep; const char* b2 = last ? nB : cB + (size_t)(t + 2) * kstep;
            const char* a3 = a2 + kstep; const char* b3 = b2 + kstep;
            if constexpr (SP2) {
            PG8_LDB(B0, 0, 0); PG8_LDB(B1, 0, 1); PG8_SCHED; PG8_LDA(At, 0, 0); PG8_STAGE(PG8_SA(1, 1), a1 + hstep, voffA);
            PG8_WAIT_V(8); PG8_WAIT_L(0); PG8_BAR; PG8_MMA(0, 0, At, B0); PG8_MMA(0, 1, At, B1); PG8_BAR; PG8_SCHED;
            PG8_LDA(At, 0, 1); PG8_STAGE(PG8_SB(0, 0), b2, voffB); PG8_STAGE(PG8_SB(0, 1), b2 + hstep, voffB); PG8_STAGE(PG8_SA(0, 0), a2, voffA);
            PG8_WAIT_V(8); PG8_WAIT_L(0); PG8_BAR; PG8_MMA(1, 0, At, B0); PG8_MMA(1, 1, At, B1); PG8_BAR; PG8_SCHED;
            PG8_LDB(B0, 1, 0); PG8_LDB(B1, 1, 1); PG8_SCHED; PG8_LDA(At, 1, 0); PG8_STAGE(PG8_SA(0, 1), a2 + hstep, voffA);
            PG8_WAIT_V(8); PG8_WAIT_L(0); PG8_BAR; PG8_MMA(0, 0, At, B0); PG8_MMA(0, 1, At, B1); PG8_BAR; PG8_SCHED;
            PG8_LDA(At, 1, 1); PG8_STAGE(PG8_SB(1, 0), b3, voffB); PG8_STAGE(PG8_SB(1, 1), b3 + hstep, voffB); PG8_STAGE(PG8_SA(1, 0), a3, voffA);
            PG8_WAIT_V(8); PG8_WAIT_L(0); PG8_BAR; PG8_MMA(1, 0, At, B0); PG8_MMA(1, 1, At, B1); PG8_BAR; PG8_SCHED;
            } else {
            PG8_LDB(B0, 0, 0); PG8_SCHED; PG8_LDA(At, 0, 0); PG8_STAGE(PG8_SA(1, 1), a1 + hstep, voffA);
            PG8_WAIT_L(8); PG8_BAR; PG8_WAIT_L(0); PG8_MMA(0, 0, At, B0); PG8_BAR; PG8_SCHED;
            PG8_LDB(B1, 0, 1); PG8_STAGE(PG8_SB(0, 0), b2, voffB);
            PG8_BAR; PG8_WAIT_L(0); PG8_MMA(0, 1, At, B1); PG8_BAR;
            PG8_LDA(At, 0, 1); PG8_STAGE(PG8_SA(0, 0), a2, voffA);
            PG8_BAR; PG8_WAIT_L(0); PG8_MMA(1, 0, At, B0); PG8_BAR; PG8_SCHED;
            PG8_STAGE(PG8_SB(0, 1), b2 + hstep, voffB);
            PG8_WAIT_V(6); PG8_BAR; PG8_MMA(1, 1, At, B1); PG8_BAR;
            PG8_LDB(B0, 1, 0); PG8_SCHED; PG8_LDA(At, 1, 0); PG8_STAGE(PG8_SA(0, 1), a2 + hstep, voffA);
            PG8_WAIT_L(8); PG8_BAR; PG8_WAIT_L(0); PG8_MMA(0, 0, At, B0); PG8_BAR; PG8_SCHED;
            PG8_LDB(B1, 1, 1); PG8_STAGE(PG8_SB(1, 0), b3, voffB);
            PG8_BAR; PG8_WAIT_L(0); PG8_MMA(0, 1, At, B1); PG8_BAR;
            PG8_LDA(At, 1, 1); PG8_STAGE(PG8_SA(1, 0), a3, voffA);
            PG8_BAR; PG8_WAIT_L(0); PG8_MMA(1, 0, At, B0); PG8_BAR; PG8_SCHED;
            PG8_STAGE(PG8_SB(1, 1), b3 + hstep, voffB);
            PG8_WAIT_V(6); PG8_BAR; PG8_MMA(1, 1, At, B1); PG8_BAR;
            }
        }
        if constexpr (ALIGN_EPI) { if (wr == 0) PG8_BAR; }
        E(acc, cur, ui, wr, wc, fr, fq);
        if (!has_next) break;
#pragma unroll
        for (int a = 0; a < 2; ++a)
#pragma unroll
            for (int b = 0; b < 2; ++b)
#pragma unroll
                for (int m = 0; m < 4; ++m)
#pragma unroll
                    for (int n = 0; n < 2; ++n) acc[a][b][m][n] = (f32x4){0.f, 0.f, 0.f, 0.f};
        cur = nxt; cA = nA; cB = nB; ++ui;
        if constexpr (ALIGN_EPI) { if (wr == 1) PG8_BAR; }
    }
    PG8_WAIT_V(0);
    if constexpr (!ALIGN_EPI) { if (wr == 0) PG8_BAR; }
    PG8_BAR;
#undef PG8_SA
#undef PG8_SB
#undef PG8_STAGE
#undef PG8_LDA
#undef PG8_LDB
#undef PG8_MMA
#undef PG8_WAIT_V
#undef PG8_WAIT_L
#undef PG8_BAR
#undef PG8_SCHED
}
}

using pg8::cvt_pk_bf16;
using pg8::Unit;
constexpr int BM = 256, HALF = 128;

__device__ __forceinline__ float fast_rcp(float x) { return __builtin_amdgcn_rcpf(x); }
__device__ __forceinline__ float fast_exp2(float x) { return __builtin_amdgcn_exp2f(x); }
__device__ __forceinline__ float sigmoidf_(float z) { return fast_rcp(1.f + fast_exp2(-z * LOG2E)); }

struct EpiSwiGLU {
    static constexpr bool PERM = true;
    bf16_t* O; const LAS float* rs;
    __device__ __forceinline__ void operator()(const f32x4 (&acc)[2][2][4][2], const Unit& u, int ui, int wr, int wc, int fr, int fq) const {
        const int col0 = u.pn * HALF + wc * 32 + 8 * fq;
#pragma unroll
        for (int ai = 0; ai < 2; ++ai)
#pragma unroll
            for (int m = 0; m < 4; ++m) {
                const int rl = ai * HALF + wr * 64 + m * 16 + fr; const float r = rs[ui * 256 + rl];
                float o[8];
#pragma unroll
                for (int n = 0; n < 2; ++n)
#pragma unroll
                    for (int e = 0; e < 4; ++e) { const float gv = acc[ai][0][m][n][e] * r, uv = acc[ai][1][m][n][e] * r; o[n * 4 + e] = gv * uv * sigmoidf_(gv); }
                u32x4 w; w.x = cvt_pk_bf16(o[0], o[1]); w.y = cvt_pk_bf16(o[2], o[3]); w.z = cvt_pk_bf16(o[4], o[5]); w.w = cvt_pk_bf16(o[6], o[7]);
                *(u32x4*)(O + (size_t)(u.pm * BM + rl) * FF + col0) = w;
            }
    }
};
struct EpiResid {
    static constexpr bool PERM = true;
    const float* base0; const float* base1; float* out; bf16_t* ob; float* ssq; float scale;
    __device__ __forceinline__ void operator()(const f32x4 (&acc)[2][2][4][2], const Unit& u, int ui, int wr, int wc, int fr, int fq) const {
#pragma unroll
        for (int ai = 0; ai < 2; ++ai)
#pragma unroll
            for (int m = 0; m < 4; ++m) {
                const int row = u.pm * BM + ai * HALF + wr * 64 + m * 16 + fr;
                const float* bp = (row < MP ? base0 : base1) + (size_t)row * D;
                float ss = 0.f;
#pragma unroll
                for (int bj = 0; bj < 2; ++bj) {
                    const int col = u.pn * BM + bj * HALF + wc * 32 + 8 * fq;
                    const f32x4 b0 = *(const f32x4*)(bp + col), b1 = *(const f32x4*)(bp + col + 4);
                    const f32x4 v0 = b0 + acc[ai][bj][m][0] * scale, v1 = b1 + acc[ai][bj][m][1] * scale;
                    *(f32x4*)(out + (size_t)row * D + col) = v0; *(f32x4*)(out + (size_t)row * D + col + 4) = v1;
                    if (ob) { u32x4 w; w.x = cvt_pk_bf16(v0[0], v0[1]); w.y = cvt_pk_bf16(v0[2], v0[3]); w.z = cvt_pk_bf16(v1[0], v1[1]); w.w = cvt_pk_bf16(v1[2], v1[3]);
                        *(u32x4*)(ob + (size_t)row * D + col) = w; }
                    ss += (v0[0] * v0[0] + v0[1] * v0[1]) + (v0[2] * v0[2] + v0[3] * v0[3]) + (v1[0] * v1[0] + v1[1] * v1[1]) + (v1[2] * v1[2] + v1[3] * v1[3]);
                }
                if (ssq) { ss += __shfl_xor(ss, 16); ss += __shfl_xor(ss, 32); if (fq == 0) ssq[(size_t)row * 32 + u.pn * 4 + wc] = ss; }
            }
    }
};
struct EpiMix {
    static constexpr bool PERM = true;
    const LAS float* rs; unsigned char* ws; float* out; const float* gq; const float* gk;
    __device__ __forceinline__ void operator()(const f32x4 (&acc)[2][2][4][2], const Unit& u, int ui, int wr, int wc, int fr, int fq) const {
        const int pn = u.pn;
        if (pn < 8) {
            const bool isq = pn < 4; const int head = 4 * (pn & 3) + wc; const float* gp = isq ? gq : gk;
            const float* ropec = (const float*)(ws + WS_ROPE); const float* ropes = ropec + 2056 * 32;
            f32x4 gv[2][2];
#pragma unroll
            for (int bj = 0; bj < 2; ++bj)
#pragma unroll
                for (int n = 0; n < 2; ++n) gv[bj][n] = *(const f32x4*)(gp + 32 * bj + 8 * fq + 4 * n);
#pragma unroll
            for (int ai = 0; ai < 2; ++ai)
#pragma unroll
                for (int m = 0; m < 4; ++m) {
                    const int rl = ai * HALF + wr * 64 + m * 16 + fr, row = u.pm * BM + rl; const float r = rs[ui * 256 + rl];
                    f32x4 z[2][2]; float ss = 0.f;
#pragma unroll
                    for (int bj = 0; bj < 2; ++bj)
#pragma unroll
                        for (int n = 0; n < 2; ++n) { z[bj][n] = acc[ai][bj][m][n] * r; ss += (z[bj][n][0] * z[bj][n][0] + z[bj][n][1] * z[bj][n][1]) + (z[bj][n][2] * z[bj][n][2] + z[bj][n][3] * z[bj][n][3]); }
                    ss += __shfl_xor(ss, 16); ss += __shfl_xor(ss, 32);
                    const float hn = 1.0f / sqrtf(ss * (1.0f / 64.0f) + EPS);
                    const int pidx = row < MP ? (row & (SEQ - 1)) : (SEQ + (row & 7));
                    f32x4 o[2][2];
#pragma unroll
                    for (int n = 0; n < 2; ++n) {
                        const f32x4 c = *(const f32x4*)(ropec + pidx * 32 + 8 * fq + 4 * n), s = *(const f32x4*)(ropes + pidx * 32 + 8 * fq + 4 * n);
                        const f32x4 x1 = z[0][n] * hn * gv[0][n], x2 = z[1][n] * hn * gv[1][n];
                        o[0][n] = x1 * c - x2 * s; o[1][n] = x2 * c + x1 * s;
                    }
                    const size_t off = (size_t)row * AW + head * 64 + 8 * fq;
#pragma unroll
                    for (int bj = 0; bj < 2; ++bj) {
                        if (isq) { const f32x4 a = o[bj][0] * QSCALE, b = o[bj][1] * QSCALE; u32x4 w; w.x = cvt_pk_bf16(a[0], a[1]); w.y = cvt_pk_bf16(a[2], a[3]); w.z = cvt_pk_bf16(b[0], b[1]); w.w = cvt_pk_bf16(b[2], b[3]);
                            *(u32x4*)((bf16_t*)(ws + WS_QB) + off + 32 * bj) = w; }
                        else { u32x4 w; w.x = cvt_pk_bf16(o[bj][0][0], o[bj][0][1]); w.y = cvt_pk_bf16(o[bj][0][2], o[bj][0][3]); w.z = cvt_pk_bf16(o[bj][1][0], o[bj][1][1]); w.w = cvt_pk_bf16(o[bj][1][2], o[bj][1][3]);
                            *(u32x4*)((bf16_t*)(ws + WS_KB) + off + 32 * bj) = w;
                            float* op = (row < MP ? out + O_KP + (size_t)row * AW : out + O_KS + (size_t)(row - MP) * AW) + head * 64 + 8 * fq + 32 * bj;
                            *(f32x4*)op = o[bj][0]; *(f32x4*)(op + 4) = o[bj][1]; }
                    }
                }
        } else if (pn < 12) {
#pragma unroll
            for (int ai = 0; ai < 2; ++ai)
#pragma unroll
                for (int m = 0; m < 4; ++m) {
                    const int rl = ai * HALF + wr * 64 + m * 16 + fr, row = u.pm * BM + rl; const float r = rs[ui * 256 + rl];
#pragma unroll
                    for (int bj = 0; bj < 2; ++bj) {
                        const int col = (pn - 8) * BM + bj * HALF + wc * 32 + 8 * fq;
                        const f32x4 v0 = acc[ai][bj][m][0] * r, v1 = acc[ai][bj][m][1] * r;
                        u32x4 w; w.x = cvt_pk_bf16(v0[0], v0[1]); w.y = cvt_pk_bf16(v0[2], v0[3]); w.z = cvt_pk_bf16(v1[0], v1[1]); w.w = cvt_pk_bf16(v1[2], v1[3]);
                        *(u32x4*)((bf16_t*)(ws + WS_VB) + (size_t)row * AW + col) = w;
                        float* op = (row < MP ? out + O_VP + (size_t)row * AW : out + O_VS + (size_t)(row - MP) * AW) + col;
                        *(f32x4*)op = v0; *(f32x4*)(op + 4) = v1;
                    }
                }
        } else {
            const int ch0 = (pn - 12) * HALF + wc * 32 + 8 * fq;
            float* U = (float*)(ws + WS_U);
#pragma unroll
            for (int ai = 0; ai < 2; ++ai)
#pragma unroll
                for (int m = 0; m < 4; ++m) {
                    const int rl = ai * HALF + wr * 64 + m * 16 + fr, row = u.pm * BM + rl; const float r = rs[ui * 256 + rl];
                    f32x4 o[2];
#pragma unroll
                    for (int n = 0; n < 2; ++n)
#pragma unroll
                        for (int e = 0; e < 4; ++e) { const float a = acc[ai][0][m][n][e] * r, b = acc[ai][1][m][n][e] * r; o[n][e] = a * sigmoidf_(b); }
                    *(f32x4*)(U + (size_t)row * CC + ch0) = o[0]; *(f32x4*)(U + (size_t)row * CC + ch0 + 4) = o[1];
                }
        }
    }
};

#define XB_TMO      128
#define XB_XCNT(j)  (256  + 64 * (j))
#define XB_XSUB(j)  (1280 + 64 * (j))
#define XB_XGEN(j)  (2304 + 64 * (j))
#define XB_TOP      3328
#define XB_TOPGEN   3392
#define XCD_BAR_WORDS 3456
#define XB_SPIN_CAP (1u << 18)
__device__ __forceinline__ unsigned xb_ld(unsigned* p)              { return __hip_atomic_load(p, __ATOMIC_RELAXED, __HIP_MEMORY_SCOPE_AGENT); }
__device__ __forceinline__ unsigned xb_add(unsigned* p, unsigned v) { return __hip_atomic_fetch_add(p, v, __ATOMIC_RELAXED, __HIP_MEMORY_SCOPE_AGENT); }
__device__ __forceinline__ unsigned xb_xcc_id() { return (unsigned)__builtin_amdgcn_s_getreg((3 << 11) | 20) & 0xFu; }
#define XB_SPIN(cond, bar) do { unsigned _sp = 0; while (cond) { __builtin_amdgcn_s_sleep(1); \
    if ((++_sp & 255u) == 0u) { if (xb_ld(&(bar)[XB_TMO])) break; if (_sp > XB_SPIN_CAP) { atomicAdd(&(bar)[XB_TMO], 1u); break; } } } } while (0)
struct XcdBarrier { unsigned* bar; unsigned x; volatile LAS unsigned* st; };
__device__ __forceinline__ XcdBarrier xcd_barrier_post(unsigned* bar, volatile LAS unsigned* st) {
    XcdBarrier b; b.bar = bar; b.x = xb_xcc_id(); b.st = st;
    if (threadIdx.x == 0) (void)xb_add(&bar[XB_XCNT(b.x)], 1u);
    return b;
}
__device__ __forceinline__ void xcd_barrier_complete(unsigned* bar, unsigned x, unsigned& nloc, unsigned& nx) {
    const unsigned G = gridDim.x * gridDim.y * gridDim.z;
    unsigned sum, cnt, mine, sp = 0u;
    for (;;) {
        sum = 0u; cnt = 0u; mine = 0u;
#pragma unroll
        for (unsigned j = 0; j < 16; ++j) { const unsigned c = xb_ld(&bar[XB_XCNT(j)]); sum += c; cnt += (c > 0u) ? 1u : 0u; mine = (j == x) ? c : mine; }
        if (sum == G) break;
        __builtin_amdgcn_s_sleep(1);
        if ((++sp & 255u) == 0u) { if (xb_ld(&bar[XB_TMO])) break; if (sp > XB_SPIN_CAP) { atomicAdd(&bar[XB_TMO], 1u); break; } }
    }
    nloc = mine > 0u ? mine : 1u; nx = cnt > 0u ? cnt : 1u;
}
__device__ __forceinline__ void xcd_barrier(const XcdBarrier& b) {
    asm volatile("s_waitcnt vmcnt(0)" ::: "memory");
    __syncthreads();
    if (threadIdx.x == 0) {
        unsigned* bar = b.bar;
        __builtin_amdgcn_s_waitcnt(0);
        unsigned nloc = b.st[0], nx = b.st[1];
        if (nloc == 0u) { xcd_barrier_complete(bar, b.x, nloc, nx); b.st[0] = nloc; b.st[1] = nx; }
        const unsigned old = xb_add(&bar[XB_XSUB(b.x)], 1u);
        const unsigned gen = old / nloc;
        if (old + 1u == (gen + 1u) * nloc) {
            __builtin_amdgcn_fence(__ATOMIC_RELEASE, "agent");
            asm volatile("s_waitcnt vmcnt(0)" ::: "memory");
            const unsigned og = xb_add(&bar[XB_TOP], 1u);
            const unsigned tg = og / nx;
            if (og + 1u == (tg + 1u) * nx) xb_add(&bar[XB_TOPGEN], 1u);
            else XB_SPIN(xb_ld(&bar[XB_TOPGEN]) == tg, bar);
            __builtin_amdgcn_fence(__ATOMIC_ACQUIRE, "agent");
            xb_add(&bar[XB_XGEN(b.x)], 1u);
            asm volatile("s_waitcnt vmcnt(0)" ::: "memory");
        } else {
            XB_SPIN(xb_ld(&bar[XB_XGEN(b.x)]) == gen, bar);
            __builtin_amdgcn_fence(__ATOMIC_ACQUIRE, "agent");
            asm volatile("s_waitcnt vmcnt(0)" ::: "memory");
        }
    }
    __syncthreads();
}

__device__ __forceinline__ unsigned f2bf(float f) { unsigned u = __builtin_bit_cast(unsigned, f); return (u + 0x7fffu + ((u >> 16) & 1u)) >> 16; }
__device__ __forceinline__ unsigned pk2(float lo, float hi) { return f2bf(lo) | (f2bf(hi) << 16); }
__device__ __forceinline__ float wave_sum(float v) {
#pragma unroll
    for (int o = 1; o < 64; o <<= 1) v += __shfl_xor(v, o);
    return v;
}

struct Args {
    const float* in[22]; float* out; unsigned char* ws; int ph_lo, ph_hi, li, pad;
};

__device__ __forceinline__ void p0_item(const float* Wa, const float* Wb, int ldw, int K, const float* gain, bf16_t* Bt, int map, int item, LAS float* scr, int lane) {
    const int nkb = K / 64, nb = item / nkb, kb = item % nkb, k0 = 64 * kb, n0 = 64 * nb;
    const int np = n0 + lane;
    const float* W = Wa; int col = np;
    if (map == 1) { const int j = np & 255; W = (j < 128) ? Wa : Wb; col = 128 * (np >> 8) + (j & 127); }
    else if (map == 2) {
        if (np < 2048) { const int j = np & 255, pnl = (np & 1023) >> 8, bj = j >> 7, wc = (j & 127) >> 5, t = j & 31; col = (np >> 10) * 1024 + (4 * pnl + wc) * 64 + 32 * bj + t; }
        else if (np < 3072) col = np;
        else { const int i = (np - 3072) >> 8, j = np & 255; col = (j < 128) ? 3072 + 128 * i + j : 4096 + 128 * i + (j - 128); }
    }
    const float* src = W + (size_t)k0 * ldw + col;
#pragma unroll 16
    for (int i = 0; i < 64; ++i) { float v = src[(size_t)i * ldw]; if (gain) v *= gain[k0 + i]; scr[i * 65 + lane] = v; }
    asm volatile("s_waitcnt lgkmcnt(0)" ::: "memory");
    const int c = lane & 7;
#pragma unroll
    for (int j = 0; j < 8; ++j) { const int n = (lane >> 3) + 8 * j; const LAS float* s = scr + (8 * c) * 65 + n;
        u32x4 o; o.x = pk2(s[0 * 65], s[1 * 65]); o.y = pk2(s[2 * 65], s[3 * 65]); o.z = pk2(s[4 * 65], s[5 * 65]); o.w = pk2(s[6 * 65], s[7 * 65]);
        *(u32x4*)(Bt + (size_t)(n0 + n) * K + k0 + 8 * c) = o; }
    asm volatile("s_waitcnt lgkmcnt(0)" ::: "memory");
}

__device__ __forceinline__ void sincos_poly(double r, float& s, float& c) {
    const double r2 = r * r;
    double ps = 1.0 / 51090942171709440000.0;
    ps = ps * r2 - 1.0 / 121645100408832000.0; ps = ps * r2 + 1.0 / 355687428096000.0; ps = ps * r2 - 1.0 / 1307674368000.0; ps = ps * r2 + 1.0 / 6227020800.0;
    ps = ps * r2 - 1.0 / 39916800.0; ps = ps * r2 + 1.0 / 362880.0; ps = ps * r2 - 1.0 / 5040.0; ps = ps * r2 + 1.0 / 120.0; ps = ps * r2 - 1.0 / 6.0; ps = ps * r2 + 1.0;
    double pc = 1.0 / 1124000727777607680000.0;
    pc = pc * r2 - 1.0 / 2432902008176640000.0; pc = pc * r2 + 1.0 / 6402373705728000.0; pc = pc * r2 - 1.0 / 20922789888000.0; pc = pc * r2 + 1.0 / 87178291200.0;
    pc = pc * r2 - 1.0 / 479001600.0; pc = pc * r2 + 1.0 / 3628800.0; pc = pc * r2 - 1.0 / 40320.0; pc = pc * r2 + 1.0 / 720.0; pc = pc * r2 - 1.0 / 24.0; pc = pc * r2 + 0.5;
    s = (float)(ps * r); c = (float)(1.0 - pc * r2);
}

struct KVTile { const void* k; const void* v; size_t rstride; int nvalid; };
__device__ __forceinline__ int crow(int r, int hi) { return (r & 3) + 8 * (r >> 2) + 4 * hi; }

template <bool F32> struct RawTile { u32x4 k[F32 ? 8 : 4]; u32x4 v[F32 ? 8 : 4]; };
template <bool F32> __device__ __forceinline__ void tile_issue(RawTile<F32>& t, const KVTile& kt, int lane) {
#pragma unroll
    for (int it = 0; it < 4; ++it) {
        int row = it * 8 + (lane >> 3); row = row < kt.nvalid ? row : kt.nvalid - 1; const int c = lane & 7;
        if constexpr (F32) {
            const float* kp = (const float*)kt.k + (size_t)row * kt.rstride + c * 8; const float* vp = (const float*)kt.v + (size_t)row * kt.rstride + c * 8;
            t.k[2 * it] = *(const u32x4*)kp; t.k[2 * it + 1] = *(const u32x4*)(kp + 4); t.v[2 * it] = *(const u32x4*)vp; t.v[2 * it + 1] = *(const u32x4*)(vp + 4);
        } else {
            const bf16_t* kp = (const bf16_t*)kt.k + (size_t)row * kt.rstride + c * 8; const bf16_t* vp = (const bf16_t*)kt.v + (size_t)row * kt.rstride + c * 8;
            t.k[it] = *(const u32x4*)kp; t.v[it] = *(const u32x4*)vp;
        }
    }
}
__device__ __forceinline__ u32x4 cvt8(u32x4 a_, u32x4 b_) {
    const f32x4 a = __builtin_bit_cast(f32x4, a_), b = __builtin_bit_cast(f32x4, b_);
    u32x4 w; w.x = pk2(a[0], a[1]); w.y = pk2(a[2], a[3]); w.z = pk2(b[0], b[1]); w.w = pk2(b[2], b[3]); return w;
}
template <bool F32> __device__ __forceinline__ void tile_write(const RawTile<F32>& t, LAS unsigned char* wl, int lane) {
    LAS unsigned char* kb = wl + (lane & 7) * 528 + (lane >> 3) * 16;
    LAS unsigned char* vb = wl + 4224 + ((lane & 7) >> 2) * 2048 + (lane >> 3) * 64 + (lane & 3) * 16;
#pragma unroll
    for (int it = 0; it < 4; ++it) {
        u32x4 kk, vv;
        if constexpr (F32) { kk = cvt8(t.k[2 * it], t.k[2 * it + 1]); vv = cvt8(t.v[2 * it], t.v[2 * it + 1]); } else { kk = t.k[it]; vv = t.v[it]; }
        *(LAS u32x4*)(kb + it * 128) = kk; *(LAS u32x4*)(vb + it * 512) = vv;
    }
}
struct AttnState { f32x16 o0, o1; float m, l; };
__device__ __forceinline__ void tile_compute(AttnState& st, const bf16x8 (&qf)[4], LAS unsigned char* wl, int lane, int maskmode) {
    const int i = lane & 31, hi = lane >> 5;
    f32x16 s = {};
    const LAS unsigned char* kp = wl + hi * 528 + i * 16;
#pragma unroll
    for (int d0 = 0; d0 < 4; ++d0) { const bf16x8 kf = __builtin_bit_cast(bf16x8, *(const LAS u32x4*)(kp + d0 * 1056)); s = __builtin_amdgcn_mfma_f32_32x32x16_bf16(kf, qf[d0], s, 0, 0, 0); }
    if (maskmode == 1) {
#pragma unroll
        for (int r = 0; r < 16; ++r) if (crow(r, hi) < i) s[r] = -INFINITY;
    } else if (maskmode == 2) {
#pragma unroll
        for (int r = 0; r < 16; ++r) if (crow(r, hi) > i) s[r] = -INFINITY;
    }
    float mx = s[0];
#pragma unroll
    for (int r = 1; r < 16; ++r) mx = fmaxf(mx, s[r]);
    mx = fmaxf(mx, __shfl_xor(mx, 32));
    const float mn = fmaxf(st.m, mx), alpha = fast_exp2(st.m - mn);
    st.m = mn;
    float ls = 0.f;
#pragma unroll
    for (int r = 0; r < 16; ++r) { s[r] = fast_exp2(s[r] - mn); ls += s[r]; }
    st.l = st.l * alpha + ls;
#pragma unroll
    for (int r = 0; r < 16; ++r) { st.o0[r] *= alpha; st.o1[r] *= alpha; }
    u32x4 p0, p1;
    p0.x = cvt_pk_bf16(s[0], s[1]); p0.y = cvt_pk_bf16(s[2], s[3]); p0.z = cvt_pk_bf16(s[4], s[5]); p0.w = cvt_pk_bf16(s[6], s[7]);
    p1.x = cvt_pk_bf16(s[8], s[9]); p1.y = cvt_pk_bf16(s[10], s[11]); p1.z = cvt_pk_bf16(s[12], s[13]); p1.w = cvt_pk_bf16(s[14], s[15]);
    const bf16x8 pf0 = __builtin_bit_cast(bf16x8, p0), pf1 = __builtin_bit_cast(bf16x8, p1);
    const LAS unsigned char* vp = wl + 4224 + (4 * hi + ((lane & 15) >> 2)) * 64 + ((lane >> 4) & 1) * 32 + (lane & 3) * 8;
#define VTR(off) __builtin_bit_cast(s16x4, __builtin_amdgcn_ds_read_tr16_b64_v4i16((LAS s16x4*)(vp + (off))))
#define VFR(dblk, sidx) ({ const s16x4 lo_ = VTR((dblk) * 2048 + (sidx) * 1024); const s16x4 hi_ = VTR((dblk) * 2048 + (sidx) * 1024 + 512); (bf16x8){lo_[0], lo_[1], lo_[2], lo_[3], hi_[0], hi_[1], hi_[2], hi_[3]}; })
    { const bf16x8 v00 = VFR(0, 0), v01 = VFR(0, 1), v10 = VFR(1, 0), v11 = VFR(1, 1);
      st.o0 = __builtin_amdgcn_mfma_f32_32x32x16_bf16(v00, pf0, st.o0, 0, 0, 0); st.o0 = __builtin_amdgcn_mfma_f32_32x32x16_bf16(v01, pf1, st.o0, 0, 0, 0);
      st.o1 = __builtin_amdgcn_mfma_f32_32x32x16_bf16(v10, pf0, st.o1, 0, 0, 0); st.o1 = __builtin_amdgcn_mfma_f32_32x32x16_bf16(v11, pf1, st.o1, 0, 0, 0); }
#undef VFR
#undef VTR
}
__device__ __forceinline__ void attn_store(const AttnState& st, float* op  , float* mlp, int lane) {
    const int hi = lane >> 5;
    const float lt = st.l + __shfl_xor(st.l, 32);
    if (op) {
#pragma unroll
        for (int g = 0; g < 4; ++g) {
            *(f32x4*)(op + 8 * g + 4 * hi) = (f32x4){st.o0[4 * g], st.o0[4 * g + 1], st.o0[4 * g + 2], st.o0[4 * g + 3]};
            *(f32x4*)(op + 32 + 8 * g + 4 * hi) = (f32x4){st.o1[4 * g], st.o1[4 * g + 1], st.o1[4 * g + 2], st.o1[4 * g + 3]};
        }
        if (hi == 0) *(f32x2*)mlp = (f32x2){st.m, lt};
    }
}

__device__ __forceinline__ void attn_prompt_task(int tix, const bf16_t* QB, const bf16_t* KB, const bf16_t* VB, float* OP, float* ML, LAS unsigned char* wl, int lane) {
    const int lo = tix & 63, bhp = tix >> 6, p = bhp >> 6, b = (bhp >> 4) & 3, h = bhp & 15;
    const int dsh = 2 * p, d = 1 << dsh;
    const int G = 64 >> dsh;
    const int r = lo / G, g = lo % G, mq0 = 32 * g;
    const int i = lane & 31, hi = lane >> 5;
    const size_t qrow = (size_t)b * SEQ + (size_t)(mq0 + i) * d + r;
    bf16x8 qf[4];
#pragma unroll
    for (int d0 = 0; d0 < 4; ++d0) qf[d0] = *(const bf16x8*)(QB + qrow * AW + h * 64 + d0 * 16 + hi * 8);
    AttnState st; st.o0 = (f32x16){}; st.o1 = (f32x16){}; st.m = -1e30f; st.l = 0.f;
    const int j0 = g >= 4 ? 0 : 4 - g;
    RawTile<false> raw;
    auto mk = [&](int j) { KVTile t; const size_t row0 = (size_t)b * SEQ + (size_t)(mq0 - 128 + 32 * j) * d + r; t.k = KB + row0 * AW + h * 64; t.v = VB + row0 * AW + h * 64; t.rstride = (size_t)d * AW; t.nvalid = 32; return t; };
    tile_issue<false>(raw, mk(j0), lane);
    for (int j = j0; j < 5; ++j) {
        tile_write<false>(raw, wl, lane);
        if (j < 4) tile_issue<false>(raw, mk(j + 1), lane);
        tile_compute(st, qf, wl, lane, j == 0 ? 1 : (j == 4 ? 2 : 0));
    }
    attn_store(st, OP + ((size_t)p * M + qrow) * AW + h * 64, ML + (((size_t)p * M + qrow) * NH + h) * 2, lane);
}
__device__ __forceinline__ void attn_sample_task(int tix, const bf16_t* QB, const bf16_t* KB, const bf16_t* VB, const float* cK, const float* cV, float* OP, float* ML, LAS unsigned char* wl, int lane) {
    const int c = tix % 13, bh = tix / 13, b = bh >> 4, h = bh & 15;
    int p, cls;
    if (c == 0) { p = 0; cls = 0; } else if (c < 5) { p = 1; cls = c - 1; } else { p = 2; cls = c - 5; }
    const int dsh = 2 * p, d = 1 << dsh, L = KVBUF >> dsh;
    const int nq = (ST - cls + d - 1) >> dsh;
    const int i = lane & 31, hi = lane >> 5;
    const int iq = i < nq ? i : 0;
    const size_t qrow = (size_t)MP + (size_t)b * ST + cls + (size_t)d * iq;
    bf16x8 qf[4];
#pragma unroll
    for (int d0 = 0; d0 < 4; ++d0) qf[d0] = *(const bf16x8*)(QB + qrow * AW + h * 64 + d0 * 16 + hi * 8);
    AttnState st; st.o0 = (f32x16){}; st.o1 = (f32x16){}; st.m = -1e30f; st.l = 0.f;
    RawTile<true> raw;
    auto mk = [&](int j) { KVTile t; const size_t pos0 = (size_t)cls + (size_t)d * (L - 128 + 32 * j); const size_t e = (((size_t)b * KVBUF + pos0) * NH + h) * HD; t.k = cK + e; t.v = cV + e; t.rstride = (size_t)d * NH * HD; t.nvalid = 32; return t; };
    tile_issue<true>(raw, mk(0), lane);
    RawTile<false> rawn;
    { KVTile t; const size_t row0 = (size_t)MP + (size_t)b * ST + cls; t.k = KB + row0 * AW + h * 64; t.v = VB + row0 * AW + h * 64; t.rstride = (size_t)d * AW; t.nvalid = nq; tile_issue<false>(rawn, t, lane); }
    for (int j = 0; j < 4; ++j) {
        tile_write<true>(raw, wl, lane);
        if (j < 3) tile_issue<true>(raw, mk(j + 1), lane);
        tile_compute(st, qf, wl, lane, j == 0 ? 1 : 0);
    }
    tile_write<false>(rawn, wl, lane);
    tile_compute(st, qf, wl, lane, 2);
    const bool ok = i < nq;
    attn_store(st, ok ? OP + ((size_t)p * M + qrow) * AW + h * 64 : nullptr, ML + (((size_t)p * M + qrow) * NH + h) * 2, lane);
}

#ifndef ATTN_NAIVE
#define ATTN_NAIVE 0
#endif
__device__ __forceinline__ float bf2f(bf16_t v) { return __builtin_bit_cast(float, (unsigned)v << 16); }
__device__ __forceinline__ void naive_attn_rowhead(int row, int h, const bf16_t* QB, const bf16_t* KB, const bf16_t* VB, const float* cK, const float* cV, bf16_t* CAT, int lane) {
    const float q = bf2f(QB[(size_t)row * AW + h * 64 + lane]);
    float lse[3], o[3];
#pragma unroll
    for (int p = 0; p < 3; ++p) {
        const int d = 1 << (2 * p);
        float m = -1e30f, l = 0.f, acc = 0.f;
        for (int j = 0; j <= 128; ++j) {
            float kv, vv; bool valid = true;
            if (row < MP) { const int pos = (row & (SEQ - 1)) - d * j; valid = pos >= 0; const size_t r2 = (size_t)(row - d * j);
                kv = valid ? bf2f(KB[r2 * AW + h * 64 + lane]) : 0.f; vv = valid ? bf2f(VB[r2 * AW + h * 64 + lane]) : 0.f; }
            else { const int b = (row - MP) >> 3, t = (row - MP) & 7; const int idx = KVBUF + t - d * j;
                if (idx >= KVBUF) { const size_t r2 = (size_t)MP + b * 8 + (idx - KVBUF); kv = bf2f(KB[r2 * AW + h * 64 + lane]); vv = bf2f(VB[r2 * AW + h * 64 + lane]); }
                else { const size_t e = (((size_t)b * KVBUF + idx) * NH + h) * HD + lane; kv = cK[e]; vv = cV[e]; } }
            if (!valid) continue;
            const float s = wave_sum(q * kv);
            const float mn = fmaxf(m, s), al = fast_exp2(m - mn), pp = fast_exp2(s - mn);
            l = l * al + pp; acc = acc * al + pp * vv; m = mn;
        }
        lse[p] = m + log2f(l); o[p] = acc / l;
    }
    const float mx = fmaxf(fmaxf(lse[0], lse[1]), lse[2]);
    const float w0 = fast_exp2(lse[0] - mx), w1 = fast_exp2(lse[1] - mx), w2 = fast_exp2(lse[2] - mx);
    const float r = (w0 * o[0] + w1 * o[1] + w2 * o[2]) / (w0 + w1 + w2);
    CAT[(size_t)row * D + h * 64 + lane] = (bf16_t)f2bf(r);
}

__device__ __forceinline__ void conv_unit(const float* U, size_t seqrow0, int tok0, int T, const float* state  , const float* dww, const float* dwb, const float* lng, const float* lnb,
                                          bf16_t* CAT, LAS float* red  , LAS float* ylds  , int tid) {
    const int lane = tid & 63, wave = tid >> 6;
    for (int ps = 0; ps < T; ps += 8) {
        float s1[8], s2[8];
#pragma unroll
        for (int tt = 0; tt < 8; ++tt) { s1[tt] = 0.f; s2[tt] = 0.f; }
#pragma unroll 1
        for (int hf = 0; hf < 2; ++hf) {
            const int c = tid + hf * 512;
            float win[38];
#pragma unroll
            for (int e = 0; e < 38; ++e) {
                const int pos = tok0 + ps + e - 30;
                if (pos >= 0) win[e] = U[(seqrow0 + pos) * CC + c];
                else if (state) win[e] = state[(size_t)(pos + 30) * CC + c];
                else win[e] = 0.f;
            }
            float y[8];
            const float bias = dwb[c];
#pragma unroll
            for (int tt = 0; tt < 8; ++tt) y[tt] = bias;
#pragma unroll
            for (int j = 0; j < CW; ++j) { const float wj = dww[j * CC + c];
#pragma unroll
                for (int tt = 0; tt < 8; ++tt) y[tt] += wj * win[tt + j]; }
#pragma unroll
            for (int tt = 0; tt < 8; ++tt) { ylds[tt * 1024 + c] = y[tt]; s1[tt] += y[tt]; s2[tt] += y[tt] * y[tt]; }
        }
#pragma unroll
        for (int tt = 0; tt < 8; ++tt) { s1[tt] = wave_sum(s1[tt]); s2[tt] = wave_sum(s2[tt]); }
        LAS float* rd = red + ((ps >> 3) & 1) * 128;
        if (lane == 0) {
#pragma unroll
            for (int tt = 0; tt < 8; ++tt) { rd[wave * 16 + tt] = s1[tt]; rd[wave * 16 + 8 + tt] = s2[tt]; }
        }
        __syncthreads();
        float mean[8], rstd[8];
#pragma unroll
        for (int tt = 0; tt < 8; ++tt) {
            float a = 0.f, q = 0.f;
#pragma unroll
            for (int wv = 0; wv < 8; ++wv) { a += rd[wv * 16 + tt]; q += rd[wv * 16 + 8 + tt]; }
            mean[tt] = a * (1.0f / CC); const float var = fmaxf(q * (1.0f / CC) - mean[tt] * mean[tt], 0.f); rstd[tt] = 1.0f / sqrtf(var + EPS);
        }
#pragma unroll 1
        for (int hf = 0; hf < 2; ++hf) {
            const int c = tid + hf * 512; const float gg = lng[c], bb = lnb[c];
#pragma unroll
            for (int tt = 0; tt < 8; ++tt) {
                const float z = (ylds[tt * 1024 + c] - mean[tt]) * rstd[tt] * gg + bb; const float o = z * sigmoidf_(z);
                CAT[(seqrow0 + tok0 + ps + tt) * D + AW + c] = (bf16_t)f2bf(o);
            }
        }
    }
    __syncthreads();
}

constexpr int N_PHASES = 9;

__device__ __forceinline__ const void* ldptr(const LAS unsigned long long* tab, int i) {
    const unsigned long long v = tab[i];
    const unsigned lo = __builtin_amdgcn_readfirstlane((unsigned)v), hi = __builtin_amdgcn_readfirstlane((unsigned)(v >> 32));
    return (const void*)(((unsigned long long)hi << 32) | lo);
}
#define INP(i) ((const float*)ldptr(PT, (i)))
#define WSP() ((unsigned char*)ldptr(PT, 23))
#define OUTP() ((float*)ldptr(PT, 22))

__global__ void __launch_bounds__(512, 2) hymba_fwd(Args args) {
    extern __shared__ __attribute__((aligned(16))) unsigned char lds_raw[];
    LAS unsigned char* lds = (LAS unsigned char*)lds_raw;
    const int wave = __builtin_amdgcn_readfirstlane(threadIdx.x >> 6);
    const int G = gridDim.x; const int bx = blockIdx.x;
    const int vcu = (G % 8 == 0) ? (bx % 8) * (G / 8) + bx / 8 : bx;
    volatile LAS unsigned* MISC = (volatile LAS unsigned*)(lds + MISC_OFF);
    {
        const int tid = threadIdx.x;
        LAS unsigned long long* PTW = (LAS unsigned long long*)(lds + PTAB_OFF);
        if (tid < 64) MISC[tid] = 0u;
        if (tid < 22) PTW[tid] = (unsigned long long)args.in[tid];
        if (tid == 22) PTW[22] = (unsigned long long)args.out;
        if (tid == 23) PTW[23] = (unsigned long long)args.ws;
    }
    __syncthreads();
#define PHASE_IDS() int z_ = 0; asm volatile("" : "+s"(z_)); const int lane = (int)__builtin_amdgcn_mbcnt_hi(~0u, __builtin_amdgcn_mbcnt_lo(~0u, (unsigned)z_)); const int tid = wave * 64 + lane; (void)tid; (void)lane
    const LAS unsigned long long* PT = (const LAS unsigned long long*)(lds + PTAB_OFF);
    const int li = args.li, lo = args.ph_lo, hiP = args.ph_hi;
    XcdBarrier bar; bar.bar = (unsigned*)(args.ws + WS_CTL) + CW_BAR + li * XCD_BAR_WORDS; bar.x = 0; bar.st = nullptr;
    if (MK_N_LAUNCHES != N_PHASES) bar = xcd_barrier_post((unsigned*)(args.ws + WS_CTL) + CW_BAR + li * XCD_BAR_WORDS, MISC + 8);
#define IN(k) (lo <= (k) && (k) < hiP)
#define BOTH(k) (IN(k) && IN((k) + 1))
#define GRID_BAR() do { if (MK_N_LAUNCHES != N_PHASES) xcd_barrier(bar); } while (0)
    LAS float* rsbuf = (LAS float*)(lds + RS_OFF);
    const int gw = vcu * 8 + wave, NGW = G * 8;

#define COMPUTE_RS(SSQP, S) do { Unit u_; for (int ui_ = 0; (S).next(ui_, u_); ++ui_) { const int row_ = u_.pm * BM + (tid >> 1); const float* p_ = (SSQP) + (size_t)row_ * 32 + (tid & 1) * 16; \
        const f32x4 a_ = *(const f32x4*)p_, b_ = *(const f32x4*)(p_ + 4), c_ = *(const f32x4*)(p_ + 8), d_ = *(const f32x4*)(p_ + 12); \
        float s_ = ((a_[0] + a_[1]) + (a_[2] + a_[3])) + ((b_[0] + b_[1]) + (b_[2] + b_[3])) + ((c_[0] + c_[1]) + (c_[2] + c_[3])) + ((d_[0] + d_[1]) + (d_[2] + d_[3])); \
        s_ += __shfl_xor(s_, 1); if ((tid & 1) == 0) rsbuf[ui_ * 256 + (tid >> 1)] = 1.0f / sqrtf(s_ * (1.0f / D) + EPS); } __syncthreads(); } while (0)

    if (IN(0)) {
        PHASE_IDS(); unsigned char* ws = WSP();
        LAS float* scr = (LAS float*)(lds + wave * 16640);
        constexpr int I_1 = (2 * FF / 64) * (D / 64), I_D = (D / 64) * (FF / 64), I_I = (NIN / 64) * (D / 64), I_O = (D / 64) * (D / 64);
        constexpr int NITEMS = 2 * I_1 + 2 * I_D + I_I + I_O;
        for (int it = gw; it < NITEMS; it += NGW) {
            int r = it;
            if (r < I_1) { p0_item(INP(6), INP(7), FF, D, INP(5), (bf16_t*)(ws + WS_BT1), 1, r, scr, lane); continue; } r -= I_1;
            if (r < I_D) { p0_item(INP(8), INP(8), D, FF, nullptr, (bf16_t*)(ws + WS_BTD1), 0, r, scr, lane); continue; } r -= I_D;
            if (r < I_I) { p0_item(INP(10), INP(10), NIN, D, INP(9), (bf16_t*)(ws + WS_BTI), 2, r, scr, lane); continue; } r -= I_I;
            if (r < I_O) { p0_item(INP(17), INP(17), D, D, nullptr, (bf16_t*)(ws + WS_BTO), 0, r, scr, lane); continue; } r -= I_O;
            if (r < I_1) { p0_item(INP(19), INP(20), FF, D, INP(18), (bf16_t*)(ws + WS_BT2), 1, r, scr, lane); continue; } r -= I_1;
            p0_item(INP(21), INP(21), D, FF, nullptr, (bf16_t*)(ws + WS_BTD2), 0, r, scr, lane);
        }
        {
            const float* x_prompt = INP(0); const float* x_sample = INP(1); bf16_t* HB = (bf16_t*)(ws + WS_HB); float* SSQ = (float*)(ws + WS_SSQ);
            for (int m = gw; m < M; m += NGW) {
                const float* xr = (m < MP ? x_prompt + (size_t)m * D : x_sample + (size_t)(m - MP) * D);
                float ss = 0.f;
#pragma unroll
                for (int j = 0; j < 4; ++j) {
                    const f32x4 a = *(const f32x4*)(xr + j * 512 + lane * 8), b = *(const f32x4*)(xr + j * 512 + lane * 8 + 4);
                    ss += (a[0] * a[0] + a[1] * a[1]) + (a[2] * a[2] + a[3] * a[3]) + (b[0] * b[0] + b[1] * b[1]) + (b[2] * b[2] + b[3] * b[3]);
                    u32x4 w; w.x = pk2(a[0], a[1]); w.y = pk2(a[2], a[3]); w.z = pk2(b[0], b[1]); w.w = pk2(b[2], b[3]);
                    *(u32x4*)(HB + (size_t)m * D + j * 512 + lane * 8) = w;
                }
                ss = wave_sum(ss);
                if (lane < 32) SSQ[(size_t)m * 32 + lane] = lane == 0 ? ss : 0.f;
            }
        }
        {
            float* ROPEC = (float*)(ws + WS_ROPE); float* ROPES = ROPEC + 2056 * 32;
            for (int e = bx * 512 + tid; e < 2056 * 32; e += G * 512) {
                const int pidx = e >> 5, i = e & 31; const float pos = (float)(pidx < SEQ ? pidx : 16384 + pidx - SEQ);
                const float inv = fast_exp2(-(float)i * (13.287712379549449f / 32.0f)); const float ang = pos * inv;
                const double a = (double)ang; const double k = rint(a * 0.15915494309189535); const double r = (a - k * 6.2831853071795862) - k * 2.4492935982947064e-16;
                float s, c; sincos_poly(r, s, c); ROPEC[e] = c; ROPES[e] = s;
            }
        }
        if (BOTH(0)) GRID_BAR();
    }

    if (IN(1)) {
        PHASE_IDS(); unsigned char* ws = WSP();
        pg8::Gemm g{(const bf16_t*)(ws + WS_HB), (const bf16_t*)(ws + WS_BT1), M, 2 * FF, D}; pg8::StaticOrder S; S.init(M, 2 * FF, G, bx);
        COMPUTE_RS((const float*)(ws + WS_SSQ), S);
        EpiSwiGLU E{(bf16_t*)(ws + WS_ACT), rsbuf};
        pg8::gemm_phase<EpiSwiGLU, pg8::StaticOrder, true, true>(lds, g, S, E, tid);
        if (BOTH(1)) GRID_BAR();
    }
    if (IN(2)) {
        PHASE_IDS(); unsigned char* ws = WSP();
        pg8::Gemm g{(const bf16_t*)(ws + WS_ACT), (const bf16_t*)(ws + WS_BTD1), M, D, FF}; pg8::StaticOrder S; S.init(M, D, G, bx);
        EpiResid E{INP(0), INP(1) - (size_t)MP * D, OUTP() + O_Y, (bf16_t*)(ws + WS_HB), (float*)(ws + WS_SSQ) + (size_t)1 * M * 32, 0.5f};
        pg8::gemm_phase<EpiResid, pg8::StaticOrder, true, true>(lds, g, S, E, tid);
        if (BOTH(2)) GRID_BAR();
    }
    if (IN(3)) {
        PHASE_IDS(); unsigned char* ws = WSP();
        pg8::Gemm g{(const bf16_t*)(ws + WS_HB), (const bf16_t*)(ws + WS_BTI), M, NIN, D}; pg8::StaticOrder S; S.init(M, NIN, G, bx);
        COMPUTE_RS((const float*)(ws + WS_SSQ) + (size_t)1 * M * 32, S);
        EpiMix E{rsbuf, ws, OUTP(), INP(11), INP(12)};
        pg8::gemm_phase<EpiMix, pg8::StaticOrder, true, true>(lds, g, S, E, tid);
        if (BOTH(3)) GRID_BAR();
    }
    if (IN(4)) {
        PHASE_IDS(); unsigned char* ws = WSP();
        {
            float* out = OUTP(); const float* U = (const float*)(ws + WS_U); const float* state_conv = INP(4);
            LAS float* red = (LAS float*)(lds + 8 * 8320); LAS float* ylds = (LAS float*)(lds + 69632);
            for (int cu = vcu; cu < 256 + SB; cu += G) {
                const bool pr = cu < 256; const int b = pr ? cu >> 6 : cu - 256, tok0 = pr ? (cu & 63) * 32 : 0;
                const size_t seqrow0 = pr ? (size_t)b * SEQ : (size_t)MP + (size_t)b * ST;
                conv_unit(U, seqrow0, tok0, pr ? 32 : ST, pr ? nullptr : state_conv + (size_t)b * CST * CC, INP(13), INP(14), INP(15), INP(16), (bf16_t*)(ws + WS_CAT), red, ylds, tid);
                if (pr) {
                    if (tok0 + 32 == SEQ) {
                        for (int e = tid; e < CST * CC / 4; e += 512) *(f32x4*)(out + O_CP + (size_t)b * CST * CC + e * 4) = *(const f32x4*)(U + ((size_t)b * SEQ + SEQ - CST) * CC + e * 4);
                    }
                } else {
                    float* oc = out + O_CS + (size_t)b * CST * CC;
                    for (int e = tid; e < (CST - ST) * CC / 4; e += 512) *(f32x4*)(oc + e * 4) = *(const f32x4*)(state_conv + ((size_t)b * CST + ST) * CC + e * 4);
                    for (int e = tid; e < ST * CC / 4; e += 512) *(f32x4*)(oc + (CST - ST) * CC + e * 4) = *(const f32x4*)(U + ((size_t)MP + (size_t)b * ST) * CC + e * 4);
                }
            }
        }
        if (ATTN_NAIVE != 1) {
            LAS unsigned char* wl = lds + wave * 8320;
            const bf16_t* QB = (const bf16_t*)(ws + WS_QB); const bf16_t* KB = (const bf16_t*)(ws + WS_KB); const bf16_t* VB = (const bf16_t*)(ws + WS_VB);
            float* OP = (float*)(ws + WS_OP); float* ML = (float*)(ws + WS_ML);
            for (int k = 0;; ++k) {
                const int t = k * NGW + gw; if (t >= 3 * NB * NH * 64) break;
                const int bhp = t >> 6, lo6 = ((t & 63) + 11 * (bhp >> 5)) & 63;
                attn_prompt_task((bhp << 6) | lo6, QB, KB, VB, OP, ML, wl, lane);
            }
            const float* cK = INP(2); const float* cV = INP(3);
            for (int t = gw; t < SB * NH * 13; t += NGW) attn_sample_task(t, QB, KB, VB, cK, cV, OP, ML, wl, lane);
        }
        if (BOTH(4)) GRID_BAR();
    }
    if (IN(5)) {
        PHASE_IDS(); unsigned char* ws = WSP();
        const float* OP = (const float*)(ws + WS_OP); const float* ML = (const float*)(ws + WS_ML); bf16_t* CAT = (bf16_t*)(ws + WS_CAT);
        if (ATTN_NAIVE) {
            const float* cK = INP(2); const float* cV = INP(3);
            const int tlo = (ATTN_NAIVE == 2) ? MP * NH : 0, thi = (ATTN_NAIVE == 3) ? MP * NH : M * NH;
            for (int t = tlo + gw; t < thi; t += NGW) naive_attn_rowhead(t >> 4, t & 15, (const bf16_t*)(ws + WS_QB), (const bf16_t*)(ws + WS_KB), (const bf16_t*)(ws + WS_VB), cK, cV, CAT, lane);
        }
        if (ATTN_NAIVE != 1)
        for (int row = (ATTN_NAIVE == 3 ? MP : 0) + gw; row < (ATTN_NAIVE == 2 ? MP : M); row += NGW) {
            const int h = lane >> 2, dd = 16 * (lane & 3);
            f32x2 ml[3]; float mx = -1e30f;
#pragma unroll
            for (int p = 0; p < 3; ++p) { ml[p] = *(const f32x2*)(ML + (((size_t)p * M + row) * NH + h) * 2); mx = fmaxf(mx, ml[p].x); }
            float den = 0.f; f32x4 o[4] = {};
#pragma unroll
            for (int p = 0; p < 3; ++p) {
                const float wgt = fast_exp2(ml[p].x - mx); den += wgt * ml[p].y;
                const float* op = OP + ((size_t)p * M + row) * AW + h * 64 + dd;
#pragma unroll
                for (int q = 0; q < 4; ++q) o[q] += *(const f32x4*)(op + 4 * q) * wgt;
            }
            const float inv = 1.0f / den;
            u32x4 w0, w1;
            w0.x = cvt_pk_bf16(o[0][0] * inv, o[0][1] * inv); w0.y = cvt_pk_bf16(o[0][2] * inv, o[0][3] * inv); w0.z = cvt_pk_bf16(o[1][0] * inv, o[1][1] * inv); w0.w = cvt_pk_bf16(o[1][2] * inv, o[1][3] * inv);
            w1.x = cvt_pk_bf16(o[2][0] * inv, o[2][1] * inv); w1.y = cvt_pk_bf16(o[2][2] * inv, o[2][3] * inv); w1.z = cvt_pk_bf16(o[3][0] * inv, o[3][1] * inv); w1.w = cvt_pk_bf16(o[3][2] * inv, o[3][3] * inv);
            *(u32x4*)(CAT + (size_t)row * D + h * 64 + dd) = w0; *(u32x4*)(CAT + (size_t)row * D + h * 64 + dd + 8) = w1;
        }
        if (BOTH(5)) GRID_BAR();
    }
    if (IN(6)) {
        PHASE_IDS(); unsigned char* ws = WSP(); float* HF = OUTP() + O_Y;
        pg8::Gemm g{(const bf16_t*)(ws + WS_CAT), (const bf16_t*)(ws + WS_BTO), M, D, D}; pg8::StaticOrder S; S.init(M, D, G, bx);
        EpiResid E{HF, HF, HF, (bf16_t*)(ws + WS_HB), (float*)(ws + WS_SSQ) + (size_t)2 * M * 32, 1.0f};
        pg8::gemm_phase<EpiResid, pg8::StaticOrder, true, true>(lds, g, S, E, tid);
        if (BOTH(6)) GRID_BAR();
    }
    if (IN(7)) {
        PHASE_IDS(); unsigned char* ws = WSP();
        pg8::Gemm g{(const bf16_t*)(ws + WS_HB), (const bf16_t*)(ws + WS_BT2), M, 2 * FF, D}; pg8::StaticOrder S; S.init(M, 2 * FF, G, bx);
        COMPUTE_RS((const float*)(ws + WS_SSQ) + (size_t)2 * M * 32, S);
        EpiSwiGLU E{(bf16_t*)(ws + WS_ACT), rsbuf};
        pg8::gemm_phase<EpiSwiGLU, pg8::StaticOrder, true, true>(lds, g, S, E, tid);
        if (BOTH(7)) GRID_BAR();
    }
    if (IN(8)) {
        PHASE_IDS(); unsigned char* ws = WSP(); float* HF = OUTP() + O_Y;
        pg8::Gemm g{(const bf16_t*)(ws + WS_ACT), (const bf16_t*)(ws + WS_BTD2), M, D, FF}; pg8::StaticOrder S; S.init(M, D, G, bx);
        EpiResid E{HF, HF, HF, nullptr, nullptr, 0.5f};
        pg8::gemm_phase<EpiResid, pg8::StaticOrder, true, true>(lds, g, S, E, tid);
    }
#undef IN
#undef BOTH
#undef GRID_BAR
#undef COMPUTE_RS
}

extern "C" void kernel_launch(void* const* d_in, const int* in_sizes, int n_in, void* d_out, int out_size, void* d_ws, size_t ws_size, hipStream_t stream) {
    static int grid = 0;
    if (grid == 0) {
        if (n_in != 22 || out_size != (int)O_END || ws_size < WS_END) { fprintf(stderr, "kernel_launch: unexpected shapes n_in %d out %d ws %zu (need %zu)\n", n_in, out_size, ws_size, (size_t)WS_END); grid = -1; return; }
        int dev = 0, cus = 0, per_cu = 0;
        if (hipGetDevice(&dev) != hipSuccess || hipDeviceGetAttribute(&cus, hipDeviceAttributeMultiprocessorCount, dev) != hipSuccess) { grid = -1; return; }
        if (hipFuncSetAttribute((const void*)hymba_fwd, hipFuncAttributeMaxDynamicSharedMemorySize, LDS_BYTES) != hipSuccess) { fprintf(stderr, "kernel_launch: hipFuncSetAttribute failed\n"); grid = -1; return; }
        if (hipOccupancyMaxActiveBlocksPerMultiprocessor(&per_cu, (const void*)hymba_fwd, 512, LDS_BYTES) != hipSuccess || per_cu < 1) { fprintf(stderr, "kernel_launch: occupancy query says %d blocks/CU\n", per_cu); per_cu = 1; }
        (void)hipGetLastError();
        grid = cus;
        if (grid > 256) grid = 256;
    }
    if (grid < 0) return;
    (void)hipMemsetAsync((char*)d_ws + WS_CTL, 0, CTL_BYTES, stream);
    Args a{};
    for (int i = 0; i < 22; ++i) a.in[i] = (const float*)d_in[i];
    a.out = (float*)d_out; a.ws = (unsigned char*)d_ws;
    if (MK_N_LAUNCHES == 1) {
        a.ph_lo = 0; a.ph_hi = N_PHASES; a.li = 0;
        hipLaunchKernelGGL(hymba_fwd, dim3(grid), dim3(512), LDS_BYTES, stream, a);
    } else {
        for (int li = 0; li < N_PHASES; ++li) { a.ph_lo = li; a.ph_hi = li + 1; a.li = 0; hipLaunchKernelGGL(hymba_fwd, dim3(grid), dim3(512), LDS_BYTES, stream, a); }
    }
}
```
